# Optimizing an MI355X kernel written in HIP

```python
import jax, jax.numpy as jnp
from jax import lax
import numpy as np

D_MODEL = 1024
BATCH = 8
SEQ = 2048
DEPTH = 1

N_META = 16
ATT_HEADS = 8
ATT_HEAD_DIM = D_MODEL // 16
ATT_WIDTH = ATT_HEADS * ATT_HEAD_DIM
KV_LATENT = D_MODEL // 8
IDX_HEADS = 4
IDX_DIM = D_MODEL // 16
TOPK_MAX = 256
Q_BLOCK = 128
ML_HEADS = 4
ML_V_DIM = D_MODEL // 8
ML_QK_DIM = ML_V_DIM // 2
ML_WIDTH = ML_HEADS * ML_V_DIM
ML_CHUNK = 64
CONV_WIDTH = 4
GATE_SOFTCAP = 15.0
M_INIT = -1e30
D_FF = ((8 * D_MODEL // 3 + 255) // 256) * 256
LN_EPS = 1e-5
IN_SIZES = (ATT_WIDTH, KV_LATENT, IDX_HEADS * IDX_DIM, IDX_DIM, IDX_HEADS,
            2 * ML_HEADS * ML_QK_DIM, ML_WIDTH, ML_WIDTH, ML_HEADS, ML_HEADS)
D_IN = sum(IN_SIZES)

kernel_name = "hymba_dsa_mlstm_macaron_deepnorm"


def layer_norm(x, g, b):
    x32 = x.astype(jnp.float32)
    mu = jnp.mean(x32, axis=-1, keepdims=True)
    var = jnp.mean(jnp.square(x32 - mu), axis=-1, keepdims=True)
    return ((x32 - mu) * lax.rsqrt(var + LN_EPS) * g + b).astype(x.dtype)


def rms_norm(x, g):
    x32 = x.astype(jnp.float32)
    return (x32 * lax.rsqrt(jnp.mean(jnp.square(x32), axis=-1, keepdims=True) + LN_EPS) * g).astype(x.dtype)


def swiglu(x, w_gate, w_up, w_down):
    return (jax.nn.silu(x @ w_gate) * (x @ w_up)) @ w_down


def softcap(x):
    return GATE_SOFTCAP * jnp.tanh(x / GATE_SOFTCAP)


def causal_dwconv(x, w):
    t_len = x.shape[1]
    xp = jnp.pad(x, ((0, 0), (CONV_WIDTH - 1, 0), (0, 0)))
    return sum(xp[:, j:j + t_len] * w[j] for j in range(CONV_WIDTH))


def dsa_block(qpos, q_lat, q_idx, w_idx, c_kv, k_idx, topk):
    t_len = c_kv.shape[1]
    logits = jnp.einsum('bqhd,bsd->bqhs', q_idx, k_idx).astype(jnp.float32)
    score = jnp.einsum('bqhs,bqh->bqs', jax.nn.relu(logits), w_idx.astype(jnp.float32))
    causal = jnp.arange(t_len)[None, :] <= qpos[:, None]
    score = jnp.where(causal[None], score, -jnp.inf)
    _, sel = lax.top_k(score, topk)
    kv_sel = jax.vmap(lambda c, i: c[i])(c_kv, sel)
    s = jnp.einsum('bqhc,bqkc->bqhk', q_lat, kv_sel).astype(jnp.float32) * (ATT_HEAD_DIM ** -0.5)
    valid = sel <= qpos[None, :, None]
    s = jnp.where(valid[:, :, None, :], s, -jnp.inf)
    p = jax.nn.softmax(s, axis=-1).astype(c_kv.dtype)
    return jnp.einsum('bqhk,bqkc->bqhc', p, kv_sel)


def dsa_attention(q_lat, q_idx, w_idx, c_kv, k_idx):
    bsz, t_len = c_kv.shape[:2]
    s_len = t_len - N_META
    topk = min(TOPK_MAX, s_len // 4)
    out_meta = dsa_block(jnp.arange(N_META), q_lat[:, :N_META], q_idx[:, :N_META],
                         w_idx[:, :N_META], c_kv, k_idx, topk)
    nb = s_len // Q_BLOCK

    def blocks(a):
        a = a[:, N_META:]
        return jnp.moveaxis(a.reshape(bsz, nb, Q_BLOCK, *a.shape[2:]), 1, 0)

    pos = (N_META + jnp.arange(s_len)).reshape(nb, Q_BLOCK)
    out = lax.map(lambda xs: dsa_block(xs[0], xs[1], xs[2], xs[3], c_kv, k_idx, topk),
                  (pos, blocks(q_lat), blocks(q_idx), blocks(w_idx)))
    out = jnp.moveaxis(out, 0, 1).reshape(bsz, s_len, *q_lat.shape[2:])
    return jnp.concatenate([out_meta, out], axis=1)


def mlstm_chunk(state, inp):
    c_st, n_st, m_st = state
    q, k, v, ig, lf = inp
    chunk = q.shape[2]
    b = jnp.cumsum(lf, axis=-1)
    causal = jnp.tril(jnp.ones((chunk, chunk), dtype=bool))
    d = jnp.where(causal, b[..., :, None] - b[..., None, :] + ig[..., None, :], -jnp.inf)
    inter = b + m_st[..., None]
    m_t = jnp.maximum(jnp.max(d, axis=-1), inter)
    w_inter = jnp.exp(inter - m_t)
    s = jnp.einsum('bhld,bhsd->bhls', q, k) * jnp.exp(d - m_t[..., None])
    num = jnp.einsum('bhls,bhsv->bhlv', s, v) + w_inter[..., None] * jnp.einsum('bhvd,bhld->bhlv', c_st, q)
    den = jnp.sum(s, axis=-1) + w_inter * jnp.einsum('bhd,bhld->bhl', n_st, q)
    h = num / jnp.maximum(jnp.abs(den), jnp.exp(-m_t))[..., None]
    b_end = b[..., -1]
    g = b_end[..., None] - b + ig
    m_new = jnp.maximum(b_end + m_st, jnp.max(g, axis=-1))
    decay = jnp.exp(b_end + m_st - m_new)
    wg = jnp.exp(g - m_new[..., None])
    c_new = decay[..., None, None] * c_st + jnp.einsum('bhl,bhlv,bhld->bhvd', wg, v, k)
    n_new = decay[..., None] * n_st + jnp.einsum('bhl,bhld->bhd', wg, k)
    return (c_new, n_new, m_new), h


def mlstm_chunkwise(q, k, v, ig, lf):
    bsz, nh, t_len, dk = q.shape
    dv = v.shape[-1]
    s_len = t_len - N_META
    nc = s_len // ML_CHUNK
    state = (jnp.zeros((bsz, nh, dv, dk), jnp.float32), jnp.zeros((bsz, nh, dk), jnp.float32),
             jnp.full((bsz, nh), M_INIT, jnp.float32))
    state, h_meta = mlstm_chunk(state, (q[:, :, :N_META], k[:, :, :N_META], v[:, :, :N_META],
                                        ig[:, :, :N_META], lf[:, :, :N_META]))

    def chunks(a):
        a = a[:, :, N_META:]
        return jnp.moveaxis(a.reshape(bsz, nh, nc, ML_CHUNK, *a.shape[3:]), 2, 0)

    _, h_real = lax.scan(mlstm_chunk, state, (chunks(q), chunks(k), chunks(v), chunks(ig), chunks(lf)))
    h_real = jnp.moveaxis(h_real, 0, 2).reshape(bsz, nh, s_len, dv)
    return jnp.concatenate([h_meta, h_real], axis=2)


def hybrid_mixer(x, w_in, w_uk, w_uv, kv_norm_g, conv_w, b_igate, b_fgate, ml_norm_g, w_out):
    bsz, t_len, _ = x.shape
    split_points = np.cumsum(IN_SIZES)[:-1].tolist()
    q_a, c_kv, q_idx, k_idx, w_idx, qk_m, v_m, o_m, i_m, f_m = jnp.split(x @ w_in, split_points, axis=-1)

    q_a = q_a.reshape(bsz, t_len, ATT_HEADS, ATT_HEAD_DIM)
    c_kv = rms_norm(c_kv, kv_norm_g)
    q_lat = jnp.einsum('bthd,hdc->bthc', q_a, w_uk)
    q_idx = q_idx.reshape(bsz, t_len, IDX_HEADS, IDX_DIM)
    w_idx = w_idx * (IDX_HEADS ** -0.5 * IDX_DIM ** -0.5)
    o_lat = dsa_attention(q_lat, q_idx, w_idx, c_kv, k_idx)
    y_att = jnp.einsum('bthc,hcd->bthd', o_lat, w_uv).reshape(bsz, t_len, ATT_WIDTH)

    qk_m = jax.nn.silu(causal_dwconv(qk_m, conv_w))
    q_m, k_m = jnp.split(qk_m, 2, axis=-1)

    def to_heads(a, dim):
        return a.reshape(bsz, t_len, ML_HEADS, dim).transpose(0, 2, 1, 3).astype(jnp.float32)

    ig = softcap(i_m + b_igate).astype(jnp.float32).transpose(0, 2, 1)
    lf = jax.nn.log_sigmoid(softcap(f_m + b_fgate).astype(jnp.float32)).transpose(0, 2, 1)
    h = mlstm_chunkwise(to_heads(q_m, ML_QK_DIM), to_heads(k_m, ML_QK_DIM) * (ML_QK_DIM ** -0.5),
                        to_heads(v_m, ML_V_DIM), ig, lf)
    mu = jnp.mean(h, axis=-1, keepdims=True)
    var = jnp.mean(jnp.square(h - mu), axis=-1, keepdims=True)
    h = (h - mu) * lax.rsqrt(var + LN_EPS) * ml_norm_g.reshape(ML_HEADS, ML_V_DIM)[:, None, :]
    h = h.transpose(0, 2, 1, 3).reshape(bsz, t_len, ML_WIDTH).astype(x.dtype)
    y_ml = jax.nn.sigmoid(o_m) * h

    return jnp.concatenate([y_att, y_ml], axis=-1) @ w_out


def setup_inputs(seed: int = 0) -> dict:
    key = jax.random.key(seed)
    ks = jax.random.split(key, 24)
    beta = (8 * DEPTH) ** -0.25
    f32 = jnp.float32

    def nrm(k, shape, scale):
        return jax.random.normal(k, shape, f32) * scale

    return {
        "x": nrm(ks[0], (BATCH, SEQ, D_MODEL), 1.0),
        "meta_tokens": nrm(ks[1], (N_META, D_MODEL), 1.0),
        "ln1_g": 1.0 + nrm(ks[2], (DEPTH, D_MODEL), 0.02),
        "ln1_b": nrm(ks[3], (DEPTH, D_MODEL), 0.02),
        "ffn1_w_gate": nrm(ks[4], (DEPTH, D_MODEL, D_FF), D_MODEL ** -0.5),
        "ffn1_w_up": nrm(ks[5], (DEPTH, D_MODEL, D_FF), D_MODEL ** -0.5),
        "ffn1_w_down": nrm(ks[6], (DEPTH, D_FF, D_MODEL), D_FF ** -0.5 * beta),
        "w_in": nrm(ks[7], (DEPTH, D_MODEL, D_IN), D_MODEL ** -0.5),
        "w_uk": nrm(ks[8], (DEPTH, ATT_HEADS, ATT_HEAD_DIM, KV_LATENT), ATT_HEAD_DIM ** -0.5),
        "w_uv": nrm(ks[9], (DEPTH, ATT_HEADS, KV_LATENT, ATT_HEAD_DIM), KV_LATENT ** -0.5),
        "kv_norm_g": 1.0 + nrm(ks[10], (DEPTH, KV_LATENT), 0.02),
        "conv_w": nrm(ks[11], (DEPTH, CONV_WIDTH, 2 * ML_HEADS * ML_QK_DIM), CONV_WIDTH ** -0.5),
        "b_igate": nrm(ks[12], (DEPTH, ML_HEADS), 0.1),
        "b_fgate": jnp.linspace(3.0, 6.0, ML_HEADS, dtype=f32)[None, :] + nrm(ks[13], (DEPTH, ML_HEADS), 0.1),
        "ml_norm_g": 1.0 + nrm(ks[14], (DEPTH, ML_WIDTH), 0.02),
        "w_out": nrm(ks[15], (DEPTH, D_MODEL, D_MODEL), D_MODEL ** -0.5 * beta),
        "ln2_g": 1.0 + nrm(ks[16], (DEPTH, D_MODEL), 0.02),
        "ln2_b": nrm(ks[17], (DEPTH, D_MODEL), 0.02),
        "ffn2_w_gate": nrm(ks[18], (DEPTH, D_MODEL, D_FF), D_MODEL ** -0.5),
        "ffn2_w_up": nrm(ks[19], (DEPTH, D_MODEL, D_FF), D_MODEL ** -0.5),
        "ffn2_w_down": nrm(ks[20], (DEPTH, D_FF, D_MODEL), D_FF ** -0.5 * beta),
        "ln3_g": 1.0 + nrm(ks[21], (DEPTH, D_MODEL), 0.02),
        "ln3_b": nrm(ks[22], (DEPTH, D_MODEL), 0.02),
    }


def reference(x, meta_tokens, ln1_g, ln1_b, ffn1_w_gate, ffn1_w_up, ffn1_w_down, w_in, w_uk, w_uv,
              kv_norm_g, conv_w, b_igate, b_fgate, ml_norm_g, w_out, ln2_g, ln2_b,
              ffn2_w_gate, ffn2_w_up, ffn2_w_down, ln3_g, ln3_b):
    alpha = (2 * DEPTH) ** 0.25
    bsz = x.shape[0]
    meta = jnp.broadcast_to(meta_tokens.astype(x.dtype)[None], (bsz, N_META, x.shape[-1]))
    h = jnp.concatenate([meta, x], axis=1)
    for l in range(DEPTH):
        h = layer_norm(alpha * h + 0.5 * swiglu(h, ffn1_w_gate[l], ffn1_w_up[l], ffn1_w_down[l]),
                       ln1_g[l], ln1_b[l])
        h = layer_norm(alpha * h + hybrid_mixer(h, w_in[l], w_uk[l], w_uv[l], kv_norm_g[l], conv_w[l],
                                                b_igate[l], b_fgate[l], ml_norm_g[l], w_out[l]),
                       ln2_g[l], ln2_b[l])
        h = layer_norm(alpha * h + 0.5 * swiglu(h, ffn2_w_gate[l], ffn2_w_up[l], ffn2_w_down[l]),
                       ln3_g[l], ln3_b[l])
    return h[:, N_META:]
```

```cpp
#include <hip/hip_runtime.h>
#include <cstdio>
#include <cstdint>

namespace nv {
constexpr int B = 8, S = 2048, D = 1024, NM = 16, T = S + NM, DFF = 2816, DIN = 2508;
constexpr int MR = B * S;
constexpr int R = MR + NM;
constexpr float ALPHA = 1.189207115002721f;
constexpr float LN_EPS = 1e-5f;
constexpr int C_QA = 0, C_KV = 512, C_QI = 640, C_KI = 896, C_WI = 960, C_QK = 964, C_V = 1476, C_O = 1988, C_IG = 2500, C_FG = 2504;

__device__ __forceinline__ int rowof(int b, int p) { return p < NM ? MR + p : b * S + (p - NM); }

__global__ void k_build_h0(const float* x, const float* meta, float* H0) {
    size_t i = (size_t)blockIdx.x * blockDim.x + threadIdx.x;
    size_t n = (size_t)R * D / 4;
    if (i >= n) return;
    size_t e = i * 4; size_t r = e / D;
    float4 v = r < MR ? *(const float4*)(x + e) : *(const float4*)(meta + (e - (size_t)MR * D));
    *(float4*)(H0 + e) = v;
}

__global__ void __launch_bounds__(256) k_gemm(const float* __restrict__ A, int lda, const float* __restrict__ W, int ldw, float* __restrict__ C, int ldc, int M, int N, int K) {
    __shared__ float As[16][65];
    __shared__ float Ws[16][64];
    const int tx = threadIdx.x & 15, ty = threadIdx.x >> 4;
    const int m0 = blockIdx.y * 64, n0 = blockIdx.x * 64;
    float acc[4][4];
#pragma unroll
    for (int i = 0; i < 4; ++i)
#pragma unroll
        for (int j = 0; j < 4; ++j) acc[i][j] = 0.f;
    for (int k0 = 0; k0 < K; k0 += 16) {
#pragma unroll
        for (int i = 0; i < 4; ++i) { int idx = threadIdx.x + i * 256; int m = idx >> 4, k = idx & 15; int gm = m0 + m; As[k][m] = gm < M ? A[(size_t)gm * lda + k0 + k] : 0.f; }
#pragma unroll
        for (int i = 0; i < 4; ++i) { int idx = threadIdx.x + i * 256; int k = idx >> 6, n = idx & 63; int gn = n0 + n; Ws[k][n] = gn < N ? W[(size_t)(k0 + k) * ldw + gn] : 0.f; }
        __syncthreads();
#pragma unroll
        for (int k = 0; k < 16; ++k) {
            float a[4], w[4];
#pragma unroll
            for (int i = 0; i < 4; ++i) a[i] = As[k][ty * 4 + i];
#pragma unroll
            for (int j = 0; j < 4; ++j) w[j] = Ws[k][tx * 4 + j];
#pragma unroll
            for (int i = 0; i < 4; ++i)
#pragma unroll
                for (int j = 0; j < 4; ++j) acc[i][j] = fmaf(a[i], w[j], acc[i][j]);
        }
        __syncthreads();
    }
#pragma unroll
    for (int i = 0; i < 4; ++i) { int gm = m0 + ty * 4 + i; if (gm >= M) continue;
#pragma unroll
        for (int j = 0; j < 4; ++j) { int gn = n0 + tx * 4 + j; if (gn < N) C[(size_t)gm * ldc + gn] = acc[i][j]; } }
}

__global__ void k_swiglu(float* G, const float* U, size_t n) {
    size_t i = (size_t)blockIdx.x * blockDim.x + threadIdx.x;
    if (i >= n) return;
    float g = G[i], u = U[i];
    G[i] = g / (1.f + expf(-g)) * u;
}

__device__ __forceinline__ float wave_sum(float v) {
#pragma unroll
    for (int o = 1; o < 64; o <<= 1) v += __shfl_xor(v, o);
    return v;
}
__device__ __forceinline__ float wave_max(float v) {
#pragma unroll
    for (int o = 1; o < 64; o <<= 1) v = fmaxf(v, __shfl_xor(v, o));
    return v;
}

__global__ void __launch_bounds__(256) k_post_ln(const float* base, const float* dm, float sc, const float* g, const float* bb, float* out, int rows) {
    const int r = blockIdx.x * 4 + (threadIdx.x >> 6), lane = threadIdx.x & 63;
    if (r >= rows) return;
    float v[16]; float s = 0.f;
#pragma unroll
    for (int j = 0; j < 16; ++j) { int c = lane + 64 * j; v[j] = ALPHA * base[(size_t)r * D + c] + sc * dm[(size_t)r * D + c]; s += v[j]; }
    const float mean = wave_sum(s) * (1.f / D); float q = 0.f;
#pragma unroll
    for (int j = 0; j < 16; ++j) { v[j] -= mean; q += v[j] * v[j]; }
    const float rstd = 1.f / sqrtf(wave_sum(q) * (1.f / D) + LN_EPS);
#pragma unroll
    for (int j = 0; j < 16; ++j) { int c = lane + 64 * j; out[(size_t)r * D + c] = v[j] * rstd * g[c] + bb[c]; }
}

__global__ void __launch_bounds__(256) k_kvnorm(float* P, const float* g) {
    const int r = blockIdx.x * 4 + (threadIdx.x >> 6), lane = threadIdx.x & 63;
    if (r >= R) return;
    float a = P[(size_t)r * DIN + C_KV + lane], b = P[(size_t)r * DIN + C_KV + 64 + lane];
    float ss = wave_sum(a * a + b * b) * (1.f / 128.f);
    float rs = 1.f / sqrtf(ss + LN_EPS);
    P[(size_t)r * DIN + C_KV + lane] = a * rs * g[lane];
    P[(size_t)r * DIN + C_KV + 64 + lane] = b * rs * g[64 + lane];
}

__global__ void __launch_bounds__(256) k_attn(const float* __restrict__ P, const float* __restrict__ w_uk, const float* __restrict__ w_uv, float* __restrict__ Y) {
    __shared__ float sc[T];
    __shared__ int sel[256];
    __shared__ float qlat[8][128];
    __shared__ float olat[128];
    __shared__ float prob[256];
    __shared__ float red[8];
    __shared__ float qi[256];
    __shared__ float wi[4];
    const int tid = threadIdx.x, lane = tid & 63, wid = tid >> 6;
    const int b = blockIdx.x / S, t = blockIdx.x % S, p = NM + t, nk = p + 1;
    const int qr = b * S + t;
    const float* qrow = P + (size_t)qr * DIN;
    qi[tid] = qrow[C_QI + tid];
    if (tid < 4) wi[tid] = qrow[C_WI + tid] * 0.0625f;
    __syncthreads();
    for (int s = tid; s < nk; s += 256) {
        const float* kr = P + (size_t)rowof(b, s) * DIN + C_KI;
        float tot = 0.f;
        for (int h = 0; h < 4; ++h) { float d = 0.f; for (int e = 0; e < 64; ++e) d = fmaf(qi[h * 64 + e], kr[e], d); tot += fmaxf(d, 0.f) * wi[h]; }
        sc[s] = tot;
    }
    __syncthreads();
    int nsel;
    if (nk <= 256) { nsel = nk; if (tid < nk) sel[tid] = tid; }
    else {
        nsel = 256;
        for (int s = tid; s < nk; s += 256) {
            const float v = sc[s]; int rank = 0;
            for (int j = 0; j < nk; ++j) { const float u = sc[j]; rank += (u > v || (u == v && j < s)) ? 1 : 0; }
            if (rank < 256) sel[rank] = s;
        }
    }
    for (int o = tid; o < 1024; o += 256) { const int h = o >> 7, c = o & 127; float a = 0.f; for (int d = 0; d < 64; ++d) a = fmaf(qrow[C_QA + h * 64 + d], w_uk[(h * 64 + d) * 128 + c], a); qlat[h][c] = a; }
    __syncthreads();
    for (int h = 0; h < 8; ++h) {
        float sv = -INFINITY;
        if (tid < nsel) { const float* kv = P + (size_t)rowof(b, sel[tid]) * DIN + C_KV; float a = 0.f; for (int c = 0; c < 128; ++c) a = fmaf(qlat[h][c], kv[c], a); sv = a * 0.125f; }
        float mx = wave_max(sv); if (lane == 0) red[wid] = mx; __syncthreads();
        mx = fmaxf(fmaxf(red[0], red[1]), fmaxf(red[2], red[3])); __syncthreads();
        float e = tid < nsel ? expf(sv - mx) : 0.f;
        float sm = wave_sum(e); if (lane == 0) red[wid] = sm; __syncthreads();
        sm = red[0] + red[1] + red[2] + red[3];
        prob[tid] = e / sm; __syncthreads();
        if (tid < 128) { float a = 0.f; for (int k = 0; k < nsel; ++k) a = fmaf(prob[k], P[(size_t)rowof(b, sel[k]) * DIN + C_KV + tid], a); olat[tid] = a; }
        __syncthreads();
        if (tid < 64) { float a = 0.f; for (int c = 0; c < 128; ++c) a = fmaf(olat[c], w_uv[(h * 128 + c) * 64 + tid], a); Y[(size_t)qr * D + h * 64 + tid] = a; }
        __syncthreads();
    }
}

__device__ __forceinline__ float softcap(float x) { return 15.f * tanhf(x * (1.f / 15.f)); }
__device__ __forceinline__ float logsigmoid(float x) { return fminf(x, 0.f) - log1pf(expf(-fabsf(x))); }
__device__ __forceinline__ float silu(float x) { return x / (1.f + expf(-x)); }

__global__ void __launch_bounds__(256) k_mlstm(float* P, const float* __restrict__ conv_w, const float* __restrict__ b_i, const float* __restrict__ b_f) {
    const int tid = threadIdx.x, vl = tid >> 4, dg = tid & 15;
    const int blk = blockIdx.x, b = blk >> 5, h = (blk >> 3) & 3, vs = blk & 7;
    const int cq = h * 64 + dg * 4, ck = 256 + h * 64 + dg * 4;
    float cw_q[4][4], cw_k[4][4];
#pragma unroll
    for (int j = 0; j < 4; ++j)
#pragma unroll
        for (int i = 0; i < 4; ++i) { cw_q[j][i] = conv_w[j * 512 + cq + i]; cw_k[j][i] = conv_w[j * 512 + ck + i]; }
    const float bi = b_i[h], bf = b_f[h];
    float Cst[4] = {0.f, 0.f, 0.f, 0.f}, nst[4] = {0.f, 0.f, 0.f, 0.f}; float m = -1e30f;
    for (int p = 0; p < T; ++p) {
        const int r = rowof(b, p);
        float q[4] = {0.f, 0.f, 0.f, 0.f}, k[4] = {0.f, 0.f, 0.f, 0.f};
#pragma unroll
        for (int j = 0; j < 4; ++j) { const int pp = p - 3 + j; if (pp < 0) continue; const float* pr = P + (size_t)rowof(b, pp) * DIN + C_QK;
#pragma unroll
            for (int i = 0; i < 4; ++i) { q[i] = fmaf(cw_q[j][i], pr[cq + i], q[i]); k[i] = fmaf(cw_k[j][i], pr[ck + i], k[i]); } }
#pragma unroll
        for (int i = 0; i < 4; ++i) { q[i] = silu(q[i]); k[i] = silu(k[i]) * 0.125f; }
        float* vp = P + (size_t)r * DIN + C_V + h * 128 + vs * 16 + vl;
        const float v = *vp;
        const float ig = softcap(P[(size_t)r * DIN + C_IG + h] + bi);
        const float lf = logsigmoid(softcap(P[(size_t)r * DIN + C_FG + h] + bf));
        const float mn = fmaxf(lf + m, ig), a = expf(lf + m - mn), bb = expf(ig - mn);
        float num = 0.f, den = 0.f;
#pragma unroll
        for (int i = 0; i < 4; ++i) { Cst[i] = a * Cst[i] + bb * v * k[i]; nst[i] = a * nst[i] + bb * k[i]; num = fmaf(Cst[i], q[i], num); den = fmaf(nst[i], q[i], den); }
#pragma unroll
        for (int o = 1; o < 16; o <<= 1) { num += __shfl_xor(num, o); den += __shfl_xor(den, o); }
        m = mn;
        const float hv = num / fmaxf(fabsf(den), expf(-mn));
        if (dg == 0 && p >= NM) *vp = hv;
    }
}

__global__ void __launch_bounds__(256) k_mlstm_out(const float* __restrict__ P, const float* __restrict__ gam, float* __restrict__ Y) {
    const int idx = blockIdx.x * 4 + (threadIdx.x >> 6), lane = threadIdx.x & 63;
    if (idx >= MR * 4) return;
    const int r = idx >> 2, h = idx & 3;
    const float* hp = P + (size_t)r * DIN + C_V + h * 128;
    float a = hp[lane], b = hp[64 + lane];
    const float mu = wave_sum(a + b) * (1.f / 128.f);
    a -= mu; b -= mu;
    const float var = wave_sum(a * a + b * b) * (1.f / 128.f);
    const float rs = 1.f / sqrtf(var + LN_EPS);
    const float* op = P + (size_t)r * DIN + C_O + h * 128;
    const float o0 = op[lane], o1 = op[64 + lane];
    Y[(size_t)r * D + 512 + h * 128 + lane] = a * rs * gam[h * 128 + lane] / (1.f + expf(-o0));
    Y[(size_t)r * D + 512 + h * 128 + 64 + lane] = b * rs * gam[h * 128 + 64 + lane] / (1.f + expf(-o1));
}

static void gemm(const float* A, int lda, const float* W, int ldw, float* C, int ldc, int M, int N, int K, hipStream_t st) {
    dim3 g((N + 63) / 64, (M + 63) / 64);
    hipLaunchKernelGGL(k_gemm, g, dim3(256), 0, st, A, lda, W, ldw, C, ldc, M, N, K);
}

static void run(void* const* d_in, float* out, unsigned char* ws, hipStream_t st) {
    const float* x = (const float*)d_in[0]; const float* meta = (const float*)d_in[1];
    const float *ln1g = (const float*)d_in[2], *ln1b = (const float*)d_in[3], *wg1 = (const float*)d_in[4], *wu1 = (const float*)d_in[5], *wd1 = (const float*)d_in[6];
    const float *w_in = (const float*)d_in[7], *w_uk = (const float*)d_in[8], *w_uv = (const float*)d_in[9], *kvg = (const float*)d_in[10], *conv_w = (const float*)d_in[11];
    const float *b_i = (const float*)d_in[12], *b_f = (const float*)d_in[13], *mlg = (const float*)d_in[14], *w_out = (const float*)d_in[15];
    const float *ln2g = (const float*)d_in[16], *ln2b = (const float*)d_in[17], *wg2 = (const float*)d_in[18], *wu2 = (const float*)d_in[19], *wd2 = (const float*)d_in[20];
    const float *ln3g = (const float*)d_in[21], *ln3b = (const float*)d_in[22];
    const size_t MiB = 1u << 20;
    float* H1 = (float*)(ws);
    float* H0 = (float*)(ws + 65 * MiB);
    float* PJ = (float*)(ws + 65 * MiB);
    float* G = (float*)(ws + 130 * MiB);
    float* U = (float*)(ws + 175 * MiB);
    float* D2 = (float*)(ws + 65 * MiB);
    float* Y = out;
    hipLaunchKernelGGL(k_build_h0, dim3((R * D / 4 + 255) / 256), dim3(256), 0, st, x, meta, H0);
    const int CH = 4100;
    for (int c = 0; c < 4; ++c) {
        const float* a = H0 + (size_t)c * CH * D;
        gemm(a, D, wg1, DFF, G, DFF, CH, DFF, D, st);
        gemm(a, D, wu1, DFF, U, DFF, CH, DFF, D, st);
        size_t n = (size_t)CH * DFF;
        hipLaunchKernelGGL(k_swiglu, dim3((unsigned)((n + 255) / 256)), dim3(256), 0, st, G, U, n);
        gemm(G, DFF, wd1, D, H1 + (size_t)c * CH * D, D, CH, D, DFF, st);
    }
    hipLaunchKernelGGL(k_post_ln, dim3((R + 3) / 4), dim3(256), 0, st, H0, H1, 0.5f, ln1g, ln1b, H1, R);
    gemm(H1, D, w_in, DIN, PJ, DIN, R, DIN, D, st);
    hipLaunchKernelGGL(k_kvnorm, dim3((R + 3) / 4), dim3(256), 0, st, PJ, kvg);
    hipLaunchKernelGGL(k_attn, dim3(MR), dim3(256), 0, st, PJ, w_uk, w_uv, Y);
    hipLaunchKernelGGL(k_mlstm, dim3(B * 4 * 8), dim3(256), 0, st, PJ, conv_w, b_i, b_f);
    hipLaunchKernelGGL(k_mlstm_out, dim3(MR), dim3(256), 0, st, PJ, mlg, Y);
    gemm(Y, D, w_out, D, D2, D, MR, D, D, st);
    hipLaunchKernelGGL(k_post_ln, dim3(MR / 4), dim3(256), 0, st, H1, D2, 1.0f, ln2g, ln2b, H1, MR);
    const int CH2 = 4096;
    for (int c = 0; c < 4; ++c) {
        const float* a = H1 + (size_t)c * CH2 * D;
        gemm(a, D, wg2, DFF, G, DFF, CH2, DFF, D, st);
        gemm(a, D, wu2, DFF, U, DFF, CH2, DFF, D, st);
        size_t n = (size_t)CH2 * DFF;
        hipLaunchKernelGGL(k_swiglu, dim3((unsigned)((n + 255) / 256)), dim3(256), 0, st, G, U, n);
        gemm(G, DFF, wd2, D, D2 + (size_t)c * CH2 * D, D, CH2, D, DFF, st);
    }
    hipLaunchKernelGGL(k_post_ln, dim3(MR / 4), dim3(256), 0, st, H1, D2, 0.5f, ln3g, ln3b, out, MR);
}
}

extern "C" void kernel_launch(void* const* d_in, const int* in_sizes, int n_in, void* d_out, int out_size, void* d_ws, size_t ws_size, hipStream_t stream) {
    nv::run(d_in, (float*)d_out, (unsigned char*)d_ws, stream);
}
```
